# Optimizing an MI355X kernel written in HIP

```python
import jax, jax.numpy as jnp
from jax import lax
import numpy as np

D_MODEL = 1024
BATCH = 8
SEQ = 2048
DEPTH = 2

N_MIXERS = 2
HEAD_DIM = 64
HEADS_PER_GROUP = 5
DIL_WINDOWS = (128, 512, 2048)
DIL_RATES = (1, 4, 16)
N_GROUPS = len(DIL_RATES)
N_ATTN_HEADS = N_GROUPS * HEADS_PER_GROUP
ATTN_WIDTH = N_ATTN_HEADS * HEAD_DIM
BLOCK = 64
ROPE_THETA = 10000.0
CONV_WIDTH = 3
D_FF = 4 * D_MODEL
EPS = 1e-6
NEG_INF = -1e30

kernel_name = "hybrid_dilated_attn_shortconv_encoder"


def rms_norm(x, g):
    xf = x.astype(jnp.float32)
    y = xf * lax.rsqrt(jnp.mean(xf * xf, axis=-1, keepdims=True) + EPS)
    return (y * g.astype(jnp.float32)).astype(x.dtype)


def rope(x, pos):
    half = HEAD_DIM // 2
    inv = ROPE_THETA ** (-jnp.arange(half, dtype=jnp.float32) / half)
    ang = pos.astype(jnp.float32)[:, None] * inv[None, :]
    cos = jnp.cos(ang)[None, :, None, :]
    sin = jnp.sin(ang)[None, :, None, :]
    xf = x.astype(jnp.float32)
    x1, x2 = xf[..., :half], xf[..., half:]
    return jnp.concatenate([x1 * cos - x2 * sin, x2 * cos + x1 * sin], axis=-1).astype(x.dtype)


def dilated_window_group(q, k, v, dilation, radius):
    Bn, S, H, Dh = q.shape
    L = S // dilation
    nblk = -(-L // BLOCK)
    Lp = nblk * BLOCK

    def to_res(t):
        return t.reshape(Bn, L, dilation, H, Dh).transpose(0, 2, 1, 3, 4)

    qb = jnp.pad(to_res(q), ((0, 0), (0, 0), (0, Lp - L), (0, 0), (0, 0)))
    qb = qb.reshape(Bn, dilation, nblk, BLOCK, H, Dh)

    def kv_blocks(t):
        tp = jnp.pad(to_res(t), ((0, 0), (0, 0), (BLOCK, Lp - L + BLOCK), (0, 0), (0, 0)))
        tp = tp.reshape(Bn, dilation, nblk + 2, BLOCK, H, Dh)
        return jnp.concatenate([tp[:, :, :-2], tp[:, :, 1:-1], tp[:, :, 2:]], axis=3)

    kb = kv_blocks(k)
    vb = kv_blocks(v)

    n_idx = jnp.arange(nblk)[:, None, None]
    qi = n_idx * BLOCK + jnp.arange(BLOCK)[None, :, None]
    kj = n_idx * BLOCK - BLOCK + jnp.arange(3 * BLOCK)[None, None, :]
    valid = (kj >= 0) & (kj < L) & (jnp.abs(qi - kj) <= radius)

    s = jnp.einsum('brnqhe,brnkhe->brnhqk', qb.astype(jnp.float32), kb.astype(jnp.float32))
    s = s * (HEAD_DIM ** -0.5)
    s = jnp.where(valid[None, None, :, None, :, :], s, NEG_INF)
    m = jnp.max(s, axis=-1, keepdims=True)
    p = jnp.exp(s - m)
    den = jnp.sum(p, axis=-1, keepdims=True)
    o = jnp.einsum('brnhqk,brnkhe->brnqhe', p / den, vb.astype(jnp.float32))
    lse = (m + jnp.log(den))[..., 0]

    o = o.reshape(Bn, dilation, Lp, H, Dh)[:, :, :L]
    o = o.transpose(0, 2, 1, 3, 4).reshape(Bn, S, H, Dh)
    lse = lse.transpose(0, 1, 2, 4, 3).reshape(Bn, dilation, Lp, H)[:, :, :L]
    lse = lse.transpose(0, 2, 1, 3).reshape(Bn, S, H)
    return o.astype(q.dtype), lse


def dilated_attention_mixer(h, w_qkv, q_norm, k_norm, w_o):
    Bn, S, _ = h.shape
    pos = jnp.arange(S)
    qkv = h @ w_qkv
    q, k, v = jnp.split(qkv, 3, axis=-1)
    q = q.reshape(Bn, S, N_ATTN_HEADS, HEAD_DIM)
    k = k.reshape(Bn, S, N_ATTN_HEADS, HEAD_DIM)
    v = v.reshape(Bn, S, N_ATTN_HEADS, HEAD_DIM)
    q = rope(rms_norm(q, q_norm), pos)
    k = rope(rms_norm(k, k_norm), pos)
    outs, lses = [], []
    for g in range(N_GROUPS):
        sl = slice(g * HEADS_PER_GROUP, (g + 1) * HEADS_PER_GROUP)
        radius = DIL_WINDOWS[g] // (2 * DIL_RATES[g])
        o_g, lse_g = dilated_window_group(q[:, :, sl], k[:, :, sl], v[:, :, sl], DIL_RATES[g], radius)
        outs.append(o_g)
        lses.append(lse_g)
    wts = jax.nn.softmax(jnp.stack(lses, axis=0), axis=0)
    o = jnp.concatenate([outs[g] * wts[g][..., None].astype(outs[g].dtype) for g in range(N_GROUPS)], axis=2)
    return o.reshape(Bn, S, ATTN_WIDTH) @ w_o


def short_conv_mixer(h, w_in, conv_w, w_out):
    bcu = h @ w_in
    b, c, u = jnp.split(bcu, 3, axis=-1)
    u = c * u
    up = jnp.pad(u, ((0, 0), (1, 1), (0, 0)))
    y = up[:, :-2] * conv_w[0] + up[:, 1:-1] * conv_w[1] + up[:, 2:] * conv_w[2]
    return (b * y) @ w_out


def sq_relu_mlp(h, w_up, w_down):
    a = jax.nn.relu(h @ w_up)
    return (a * a) @ w_down


def setup_inputs(seed: int = 0) -> dict:
    key = jax.random.key(seed)
    ks = jax.random.split(key, 20)
    f32 = jnp.float32

    def dense(k, fi, fo):
        return jax.random.normal(k, (fi, fo), f32) * fi ** -0.5

    def gain(k, n):
        return 1.0 + 0.02 * jax.random.normal(k, (n,), f32)

    return {
        "x": jax.random.normal(ks[0], (BATCH, SEQ, D_MODEL), f32),
        "l0_norm_mix": gain(ks[1], D_MODEL),
        "l0_w_qkv": dense(ks[2], D_MODEL, 3 * ATTN_WIDTH),
        "l0_q_norm": gain(ks[3], HEAD_DIM),
        "l0_k_norm": gain(ks[4], HEAD_DIM),
        "l0_w_o": dense(ks[5], ATTN_WIDTH, D_MODEL),
        "l0_norm_mlp": gain(ks[6], D_MODEL),
        "l0_w_up": dense(ks[7], D_MODEL, D_FF),
        "l0_w_down": dense(ks[8], D_FF, D_MODEL),
        "l1_norm_mix": gain(ks[9], D_MODEL),
        "l1_w_in": dense(ks[10], D_MODEL, 3 * D_MODEL),
        "l1_conv_w": jax.random.normal(ks[11], (CONV_WIDTH, D_MODEL), f32) * CONV_WIDTH ** -0.5,
        "l1_w_out": dense(ks[12], D_MODEL, D_MODEL),
        "l1_norm_mlp": gain(ks[13], D_MODEL),
        "l1_w_up": dense(ks[14], D_MODEL, D_FF),
        "l1_w_down": dense(ks[15], D_FF, D_MODEL),
        "final_norm": gain(ks[16], D_MODEL),
    }


def reference(x, l0_norm_mix, l0_w_qkv, l0_q_norm, l0_k_norm, l0_w_o, l0_norm_mlp, l0_w_up, l0_w_down,
              l1_norm_mix, l1_w_in, l1_conv_w, l1_w_out, l1_norm_mlp, l1_w_up, l1_w_down, final_norm):
    norm_mix = [l0_norm_mix, l1_norm_mix]
    norm_mlp = [l0_norm_mlp, l1_norm_mlp]
    mixer_params = [(l0_w_qkv, l0_q_norm, l0_k_norm, l0_w_o), (l1_w_in, l1_conv_w, l1_w_out)]
    mlp_params = [(l0_w_up, l0_w_down), (l1_w_up, l1_w_down)]
    for i in range(DEPTH):
        h = rms_norm(x, norm_mix[i])
        if i % N_MIXERS == 0:
            x = x + dilated_attention_mixer(h, *mixer_params[i])
        else:
            x = x + short_conv_mixer(h, *mixer_params[i])
        x = x + sq_relu_mlp(rms_norm(x, norm_mlp[i]), *mlp_params[i])
    return rms_norm(x, final_norm)
```

```cpp
#include <hip/hip_runtime.h>
#include <hip/hip_cooperative_groups.h>
#include <cstdio>
#include <cstdint>
#include <cmath>
namespace cg = cooperative_groups;
namespace pg8 {
#define PG8_LAS __attribute__((address_space(3)))
typedef unsigned short bf16_t;
typedef short bf16x8 __attribute__((ext_vector_type(8)));
typedef float f32x4 __attribute__((ext_vector_type(4)));
typedef unsigned u32x4 __attribute__((ext_vector_type(4)));
constexpr int BM = 256, BK = 64, HALF = 128, HTB = HALF * BK * 2  , STAGE_BYTES = 8 * HTB, NXCD = 8, WGM = 8;

__host__ __device__ __forceinline__ int lds_byte(int r, int c) { const int st = (r >> 4) * 2 + (c >> 5), rr = r & 15, cc = c & 31, ob = rr * 64 + cc * 2; return st * 1024 + (ob ^ (((ob >> 9) & 1) << 5)); }
__host__ __device__ __forceinline__ void stage_rc(int b, int& R, int& C) { const int st = b / 1024, sb = b % 1024, swz = sb ^ (((sb >> 9) & 1) << 5); R = (st >> 1) * 16 + swz / 64; C = (st & 1) * 32 + (swz % 64) / 2; }
__host__ __device__ __forceinline__ int perm32(int rho) { const int n = rho >> 4, i = rho & 15; return 8 * (i >> 2) + 4 * n + (i & 3); }

struct Unit { int pm, pn; };
struct Gemm { const bf16_t* A; const bf16_t* Bt; int M, N, K; };

struct StaticOrder {
    int nM, nN, nwg, G, c;
    __host__ __device__ void init(int M, int N, int G_, int c_) { nM = M / BM; nN = N / BM; nwg = nM * nN; G = G_; c = c_; }
    __host__ __device__ bool next(int i, Unit& u) const {
        const long L = (long)i * G + c; if (L >= nwg) return false;
        int wgid = (int)L; { const int q = nwg / NXCD, r = nwg % NXCD, xcd = wgid % NXCD, off = wgid / NXCD; wgid = (xcd < r ? xcd * (q + 1) : r * (q + 1) + (xcd - r) * q) + off; }
        const int nig = WGM * nN, gid = wgid / nig, fm = gid * WGM, gsz = (nM - fm) < WGM ? (nM - fm) : WGM;
        u.pm = fm + ((wgid % nig) % gsz); u.pn = (wgid % nig) / gsz; return true;
    }
    __device__ __forceinline__ void a_ready(const Unit&) const {}
    __device__ __forceinline__ void done(const Unit&) const {}
};
__device__ __forceinline__ unsigned cvt_pk_bf16(float lo, float hi) { unsigned r; asm volatile("v_cvt_pk_bf16_f32 %0, %1, %2" : "=v"(r) : "v"(lo), "v"(hi)); return r; }
typedef unsigned u32x2 __attribute__((ext_vector_type(2)));
constexpr float RMS_EPS = 1e-6f;
template <int ACT> struct EpiBf16S {
    static constexpr bool PERM = true, AFTER_DRAIN = false;
    bf16_t* O; int ldc; const float* ss;
    __device__ __forceinline__ void operator()(const f32x4 (&acc)[2][2][4][2], const Unit& u, int wr, int wc, int fr, int fq) const {
        const int row0 = u.pm * BM + wr * 64 + fr; const int col0 = u.pn * BM + wc * 32 + 8 * fq;
#pragma unroll
        for (int ai = 0; ai < 2; ++ai)
#pragma unroll
            for (int m = 0; m < 4; ++m) { const int row = row0 + ai * HALF + m * 16; bf16_t* rowp = O + (size_t)row * ldc + col0;
                float rs = 1.f; if (ss) rs = __builtin_amdgcn_rsqf(ss[row] * (1.0f / 1024.0f) + RMS_EPS);
#pragma unroll
                for (int bj = 0; bj < 2; ++bj) { f32x4 v0 = acc[ai][bj][m][0] * rs, v1 = acc[ai][bj][m][1] * rs;
                    if (ACT == 1) {
#pragma unroll
                        for (int e = 0; e < 4; ++e) { const float a = fmaxf(v0[e], 0.f), b = fmaxf(v1[e], 0.f); v0[e] = a * a; v1[e] = b * b; } }
                    u32x4 w; w.x = cvt_pk_bf16(v0[0], v0[1]); w.y = cvt_pk_bf16(v0[2], v0[3]); w.z = cvt_pk_bf16(v1[0], v1[1]); w.w = cvt_pk_bf16(v1[2], v1[3]);
                    *(u32x4*)(rowp + bj * HALF) = w; } }
    }
};
struct EpiRes {
    static constexpr bool PERM = false, AFTER_DRAIN = false;
    const float* base; float* out; bf16_t* xn; const float* gain; float* ss; int ldc;
    __device__ __forceinline__ void operator()(const f32x4 (&acc)[2][2][4][2], const Unit& u, int wr, int wc, int fr, int fq) const {
        const int col0 = u.pn * BM + wc * 32 + 4 * fq;
        f32x4 gv[2][2];
#pragma unroll
        for (int bj = 0; bj < 2; ++bj)
#pragma unroll
            for (int n = 0; n < 2; ++n) gv[bj][n] = xn ? *(const f32x4*)(gain + col0 + bj * HALF + n * 16) : (f32x4){0.f, 0.f, 0.f, 0.f};
#pragma unroll
        for (int ai = 0; ai < 2; ++ai)
#pragma unroll
            for (int m = 0; m < 4; ++m) { const int r = u.pm * BM + ai * HALF + wr * 64 + m * 16 + fr; const size_t off = (size_t)r * ldc + col0; float q = 0.f;
#pragma unroll
                for (int bj = 0; bj < 2; ++bj)
#pragma unroll
                    for (int n = 0; n < 2; ++n) { const f32x4 bs = *(const f32x4*)(base + off + bj * HALF + n * 16); const f32x4 v = bs + acc[ai][bj][m][n];
                        *(f32x4*)(out + off + bj * HALF + n * 16) = v; q += (v[0] * v[0] + v[1] * v[1]) + (v[2] * v[2] + v[3] * v[3]);
                        if (xn) { const f32x4 o = v * gv[bj][n]; u32x2 w; w.x = cvt_pk_bf16(o[0], o[1]); w.y = cvt_pk_bf16(o[2], o[3]); *(u32x2*)(xn + off + bj * HALF + n * 16) = w; } }
                q += __shfl_xor(q, 16); q += __shfl_xor(q, 32);
                if (fq == 0) unsafeAtomicAdd(ss + r, q);
                asm volatile("" ::: "memory"); }
    }
};
template <class Epi, class Sched, bool ALIGN_EPI = false, bool SP2 = false>
__device__ __forceinline__ void gemm_phase(PG8_LAS unsigned char* lds, const Gemm g, const Sched& S, const Epi& E) {
    const int tid = threadIdx.x, wid = __builtin_amdgcn_readfirstlane(tid >> 6), lane = tid & 63, wr = wid >> 2, wc = wid & 3, fr = lane & 15, fq = lane >> 4;
    const int K = g.K, nt = K / BK;
    unsigned voffA[2], voffB[2];
#pragma unroll
    for (int i = 0; i < 2; ++i) { int R, C; stage_rc(tid * 16 + i * 8192, R, C); const int Rb = Epi::PERM ? ((R & ~31) + perm32(R & 31)) : R;
        voffA[i] = (unsigned)(R * K + C) * 2u; voffB[i] = (unsigned)(Rb * K + C) * 2u; }
    const size_t kstep = (size_t)(BK * 2);
    const size_t hstep = (size_t)HALF * K * 2;
    const size_t tstep = 2 * hstep;
    const unsigned ldsw = (unsigned)wid * 1024u;
    const int aoff = lds_byte(wr * 64 + fr, fq * 8), boff = lds_byte(wc * 32 + fr, fq * 8);
#define PG8_SA(b, h) (((b) * 2 + (h)) * HTB)
#define PG8_SB(b, h) ((4 + (b) * 2 + (h)) * HTB)
#define PG8_STAGE(bufoff, gbase, voff) do { _Pragma("unroll") for (int _i = 0; _i < 2; ++_i) \
        __builtin_amdgcn_global_load_lds((const unsigned*)((const char*)(gbase) + (voff)[_i]), (PG8_LAS unsigned*)(lds + (bufoff) + ldsw + _i * 8192), 16, 0, 0); } while (0)
#define PG8_LDA(dst, b, h) do { _Pragma("unroll") for (int m = 0; m < 4; ++m) _Pragma("unroll") for (int k = 0; k < 2; ++k) dst[m][k] = *(const PG8_LAS bf16x8*)(lds + PG8_SA(b, h) + aoff + m * 2048 + k * 1024); } while (0)
#define PG8_LDB(dst, b, h) do { _Pragma("unroll") for (int n = 0; n < 2; ++n) _Pragma("unroll") for (int k = 0; k < 2; ++k) dst[n][k] = *(const PG8_LAS bf16x8*)(lds + PG8_SB(b, h) + boff + n * 2048 + k * 1024); } while (0)
#define PG8_MMA(ai, bj, At, Bt) do { __builtin_amdgcn_s_setprio(1); _Pragma("unroll") for (int m = 0; m < 4; ++m) _Pragma("unroll") for (int n = 0; n < 2; ++n) _Pragma("unroll") for (int k = 0; k < 2; ++k) \
        acc[ai][bj][m][n] = __builtin_amdgcn_mfma_f32_16x16x32_bf16(Bt[n][k], At[m][k], acc[ai][bj][m][n], 0, 0, 0); __builtin_amdgcn_s_setprio(0); } while (0)
#define PG8_WAIT_V(n) asm volatile("s_waitcnt vmcnt(" #n ")" ::: "memory")
#define PG8_WAIT_L(n) asm volatile("s_waitcnt lgkmcnt(" #n ")" ::: "memory")
#define PG8_BAR __builtin_amdgcn_s_barrier()
#define PG8_SCHED __builtin_amdgcn_sched_barrier(0)
    Unit cur, nxt; int ui = 0;
    if (!S.next(0, cur)) return;
    f32x4 acc[2][2][4][2];
#pragma unroll
    for (int a = 0; a < 2; ++a)
#pragma unroll
        for (int b = 0; b < 2; ++b)
#pragma unroll
            for (int m = 0; m < 4; ++m)
#pragma unroll
                for (int n = 0; n < 2; ++n) acc[a][b][m][n] = (f32x4){0.f, 0.f, 0.f, 0.f};
    bf16x8 At[4][2], B0[2][2], B1[2][2];
    const char* cA = (const char*)g.A + (size_t)cur.pm * tstep; const char* cB = (const char*)g.Bt + (size_t)cur.pn * tstep;
    S.a_ready(cur);
    if constexpr (SP2) {
        PG8_STAGE(PG8_SB(0, 0), cB, voffB); PG8_STAGE(PG8_SB(0, 1), cB + hstep, voffB); PG8_STAGE(PG8_SA(0, 0), cA, voffA); PG8_STAGE(PG8_SA(0, 1), cA + hstep, voffA);
        if (wr == 1) PG8_BAR;
        PG8_WAIT_V(2); PG8_BAR;
        PG8_STAGE(PG8_SB(1, 0), cB + kstep, voffB); PG8_STAGE(PG8_SA(1, 0), cA + kstep, voffA); PG8_STAGE(PG8_SB(1, 1), cB + hstep + kstep, voffB);
        PG8_WAIT_V(6); PG8_BAR;
    } else {
        PG8_STAGE(PG8_SB(0, 0), cB, voffB); PG8_STAGE(PG8_SA(0, 0), cA, voffA); PG8_STAGE(PG8_SB(0, 1), cB + hstep, voffB); PG8_STAGE(PG8_SA(0, 1), cA + hstep, voffA);
        if (wr == 1) PG8_BAR;
        PG8_WAIT_V(4); PG8_BAR;
        PG8_STAGE(PG8_SB(1, 0), cB + kstep, voffB); PG8_STAGE(PG8_SA(1, 0), cA + kstep, voffA); PG8_STAGE(PG8_SB(1, 1), cB + hstep + kstep, voffB);
        PG8_WAIT_V(6); PG8_BAR;
    }
    for (;;) {
        const bool has_next = S.next(ui + 1, nxt);
        const char* nA = has_next ? (const char*)g.A + (size_t)nxt.pm * tstep : cA; const char* nB = has_next ? (const char*)g.Bt + (size_t)nxt.pn * tstep : cB;
        for (int t = 0; t < nt; t += 2) {
            const bool last = (t == nt - 2);
            const char* a1 = cA + (size_t)(t + 1) * kstep;
            const char* a2 = last ? nA : cA + (size_t)(t + 2) * kstep; const char* b2 = last ? nB : cB + (size_t)(t + 2) * kstep;
            const char* a3 = a2 + kstep; const char* b3 = b2 + kstep;
            if (last && has_next) S.a_ready(nxt);
            if constexpr (SP2) {
            PG8_LDB(B0, 0, 0); PG8_LDB(B1, 0, 1); PG8_SCHED; PG8_LDA(At, 0, 0); PG8_STAGE(PG8_SA(1, 1), a1 + hstep, voffA);
            PG8_WAIT_V(8); PG8_WAIT_L(0); PG8_BAR; PG8_MMA(0, 0, At, B0); PG8_MMA(0, 1, At, B1); PG8_BAR; PG8_SCHED;
            PG8_LDA(At, 0, 1); PG8_STAGE(PG8_SB(0, 0), b2, voffB); PG8_STAGE(PG8_SB(0, 1), b2 + hstep, voffB); PG8_STAGE(PG8_SA(0, 0), a2, voffA);
            PG8_WAIT_V(8); PG8_WAIT_L(0); PG8_BAR; PG8_MMA(1, 0, At, B0); PG8_MMA(1, 1, At, B1); PG8_BAR; PG8_SCHED;
            PG8_LDB(B0, 1, 0); PG8_LDB(B1, 1, 1); PG8_SCHED; PG8_LDA(At, 1, 0); PG8_STAGE(PG8_SA(0, 1), a2 + hstep, voffA);
            PG8_WAIT_V(8); PG8_WAIT_L(0); PG8_BAR; PG8_MMA(0, 0, At, B0); PG8_MMA(0, 1, At, B1); PG8_BAR; PG8_SCHED;
            PG8_LDA(At, 1, 1); PG8_STAGE(PG8_SB(1, 0), b3, voffB); PG8_STAGE(PG8_SB(1, 1), b3 + hstep, voffB); PG8_STAGE(PG8_SA(1, 0), a3, voffA);
            PG8_WAIT_V(8); PG8_WAIT_L(0); PG8_BAR; PG8_MMA(1, 0, At, B0); PG8_MMA(1, 1, At, B1); PG8_BAR; PG8_SCHED;
            } else {
            PG8_LDB(B0, 0, 0); PG8_SCHED; PG8_LDA(At, 0, 0); PG8_STAGE(PG8_SA(1, 1), a1 + hstep, voffA);
            PG8_WAIT_L(8); PG8_BAR; PG8_WAIT_L(0); PG8_MMA(0, 0, At, B0); PG8_BAR; PG8_SCHED;
            PG8_LDB(B1, 0, 1); PG8_STAGE(PG8_SB(0, 0), b2, voffB);
            PG8_BAR; PG8_WAIT_L(0); PG8_MMA(0, 1, At, B1); PG8_BAR;
            PG8_LDA(At, 0, 1); PG8_STAGE(PG8_SA(0, 0), a2, voffA);
            PG8_BAR; PG8_WAIT_L(0); PG8_MMA(1, 0, At, B0); PG8_BAR; PG8_SCHED;
            PG8_STAGE(PG8_SB(0, 1), b2 + hstep, voffB);
            PG8_WAIT_V(6); PG8_BAR; PG8_MMA(1, 1, At, B1); PG8_BAR;
            PG8_LDB(B0, 1, 0); PG8_SCHED; PG8_LDA(At, 1, 0); PG8_STAGE(PG8_SA(0, 1), a2 + hstep, voffA);
            PG8_WAIT_L(8); PG8_BAR; PG8_WAIT_L(0); PG8_MMA(0, 0, At, B0); PG8_BAR; PG8_SCHED;
            PG8_LDB(B1, 1, 1); PG8_STAGE(PG8_SB(1, 0), b3, voffB);
            PG8_BAR; PG8_WAIT_L(0); PG8_MMA(0, 1, At, B1); PG8_BAR;
            PG8_LDA(At, 1, 1); PG8_STAGE(PG8_SA(1, 0), a3, voffA);
            PG8_BAR; PG8_WAIT_L(0); PG8_MMA(1, 0, At, B0); PG8_BAR; PG8_SCHED;
            PG8_STAGE(PG8_SB(1, 1), b3 + hstep, voffB);
            PG8_WAIT_V(6); PG8_BAR; PG8_MMA(1, 1, At, B1); PG8_BAR;
            }
        }
        if constexpr (ALIGN_EPI) { if (wr == 0) PG8_BAR; }
        if constexpr (!Epi::AFTER_DRAIN) { E(acc, cur, wr, wc, fr, fq); S.done(cur); }
        if (!has_next) break;
#pragma unroll
        for (int a = 0; a < 2; ++a)
#pragma unroll
            for (int b = 0; b < 2; ++b)
#pragma unroll
                for (int m = 0; m < 4; ++m)
#pragma unroll
                    for (int n = 0; n < 2; ++n) acc[a][b][m][n] = (f32x4){0.f, 0.f, 0.f, 0.f};
        cur = nxt; cA = nA; cB = nB; ++ui;
        if constexpr (ALIGN_EPI) { if (wr == 1) PG8_BAR; }
    }
    PG8_WAIT_V(0);
    if constexpr (!ALIGN_EPI) { if (wr == 0) PG8_BAR; }
    PG8_BAR;
    if constexpr (Epi::AFTER_DRAIN) { E.fused(acc, cur, wr, wc, fr, fq, lds, wid, lane); S.done(cur); }
#undef PG8_SA
#undef PG8_SB
#undef PG8_STAGE
#undef PG8_LDA
#undef PG8_LDB
#undef PG8_MMA
#undef PG8_WAIT_V
#undef PG8_WAIT_L
#undef PG8_BAR
#undef PG8_SCHED
}
}
constexpr int NWAVES = 8;
constexpr int BATCH = 8, SEQ = 2048, D = 1024, FF = 4096, NH = 15, HD = 64, AW = 960;
constexpr int M = BATCH * SEQ;
constexpr int NQKV = 3072;
constexpr int N_IN = 17;
#ifndef MK_PER_PHASE
#define MK_PER_PHASE 0
#endif
#ifndef MK_CG_SYNC
#define MK_CG_SYNC 0
#endif
constexpr int N_PHASES = 13;
constexpr size_t MiB = 1u << 20;
constexpr size_t WS_CTL = 0, CTL_ZERO_BYTES = 1 * MiB;
constexpr size_t WS_SS = 512 * 1024;
constexpr size_t WS_CS = 1 * MiB;
constexpr size_t WS_LSE = 2 * MiB;
constexpr size_t WS_WQKV = 4 * MiB, WS_WO = 10 * MiB, WS_WU0 = 12 * MiB, WS_WD0 = 20 * MiB, WS_WIN = 28 * MiB, WS_WOUT = 34 * MiB, WS_WU1 = 36 * MiB, WS_WD1 = 44 * MiB;
constexpr size_t WS_XN = 52 * MiB;
constexpr size_t WS_BIG = 84 * MiB;
constexpr size_t WS_O = WS_BIG + 96 * MiB, WS_END = WS_BIG + 128 * MiB;
constexpr int CW_BAR = 4096;
constexpr int RING_OFF = 0, RING_BYTES = 131072;
constexpr int LDSCTL_OFF = RING_BYTES, MISC_OFF = LDSCTL_OFF + 320;
constexpr int LDS_BYTES = 147456;
static_assert(MISC_OFF + 128 <= LDS_BYTES, "LDS map");
#define GAS __attribute__((address_space(1)))
#define LAS __attribute__((address_space(3)))
typedef unsigned short bf16;
typedef unsigned v4u __attribute__((ext_vector_type(4)));
typedef float f32x4 __attribute__((ext_vector_type(4)));
typedef short bf16x8 __attribute__((ext_vector_type(8)));
typedef GAS unsigned gu32;
typedef GAS unsigned long long gu64;
#define RLX_AGENT __ATOMIC_RELAXED, __HIP_MEMORY_SCOPE_AGENT
#define LDS_WAIT() asm volatile("s_waitcnt lgkmcnt(0)" ::: "memory")
#define VM_WAIT() asm volatile("s_waitcnt vmcnt(0)" ::: "memory")
__device__ __forceinline__ unsigned long long rt() { return __builtin_amdgcn_s_memrealtime(); }
__device__ __forceinline__ unsigned f2bf(float f) { unsigned u = __builtin_bit_cast(unsigned, f); return (u + 0x7fffu + ((u >> 16) & 1u)) >> 16; }
__device__ __forceinline__ unsigned pk2(float lo, float hi) { return f2bf(lo) | (f2bf(hi) << 16); }

#define XB_TMO      128
#define XB_XCNT(j)  (256  + 64 * (j))
#define XB_XSUB(j)  (1280 + 64 * (j))
#define XB_XGEN(j)  (2304 + 64 * (j))
#define XB_TOP      3328
#define XB_TOPGEN   3392
#define XCD_BAR_WORDS 3456
#define XB_SPIN_CAP (1u << 18)

__device__ __forceinline__ unsigned xb_ld(unsigned* p)              { return __hip_atomic_load(p, __ATOMIC_RELAXED, __HIP_MEMORY_SCOPE_AGENT); }
__device__ __forceinline__ unsigned xb_add(unsigned* p, unsigned v) { return __hip_atomic_fetch_add(p, v, __ATOMIC_RELAXED, __HIP_MEMORY_SCOPE_AGENT); }
__device__ __forceinline__ unsigned xb_xcc_id() { return (unsigned)__builtin_amdgcn_s_getreg((3 << 11) | 20) & 0xFu; }
#define XB_SPIN(cond, bar) do { unsigned _sp = 0; while (cond) { __builtin_amdgcn_s_sleep(1); \
    if ((++_sp & 255u) == 0u) { if (xb_ld(&(bar)[XB_TMO])) break; if (_sp > XB_SPIN_CAP) { atomicAdd(&(bar)[XB_TMO], 1u); break; } } } } while (0)

struct XcdBarrier {
    unsigned* bar; unsigned x;
    volatile LAS unsigned* st;
};

__device__ __forceinline__ XcdBarrier xcd_barrier_post(unsigned* bar, volatile LAS unsigned* st) {
    XcdBarrier b; b.bar = bar; b.x = xb_xcc_id(); b.st = st;
    if (threadIdx.x == 0) (void)xb_add(&bar[XB_XCNT(b.x)], 1u);
    return b;
}
__device__ __forceinline__ void xcd_barrier_complete(unsigned* bar, unsigned x, unsigned& nloc, unsigned& nx) {
    const unsigned G = gridDim.x * gridDim.y * gridDim.z;
    unsigned sum, cnt, mine, sp = 0u;
    for (;;) {
        sum = 0u; cnt = 0u; mine = 0u;
#pragma unroll
        for (unsigned j = 0; j < 16; ++j) { const unsigned c = xb_ld(&bar[XB_XCNT(j)]); sum += c; cnt += (c > 0u) ? 1u : 0u; mine = (j == x) ? c : mine; }
        if (sum == G) break;
        __builtin_amdgcn_s_sleep(1);
        if ((++sp & 255u) == 0u) { if (xb_ld(&bar[XB_TMO])) break; if (sp > XB_SPIN_CAP) { atomicAdd(&bar[XB_TMO], 1u); break; } }
    }
    nloc = mine > 0u ? mine : 1u; nx = cnt > 0u ? cnt : 1u;
}

__device__ __forceinline__ void xcd_barrier(const XcdBarrier& b) {
    asm volatile("s_waitcnt vmcnt(0)" ::: "memory");
    __syncthreads();
    if (threadIdx.x == 0) {
        unsigned* bar = b.bar;
        __builtin_amdgcn_s_waitcnt(0);
        unsigned nloc = b.st[0], nx = b.st[1];
        if (nloc == 0u) { xcd_barrier_complete(bar, b.x, nloc, nx); b.st[0] = nloc; b.st[1] = nx; }
        const unsigned old = xb_add(&bar[XB_XSUB(b.x)], 1u);
        const unsigned gen = old / nloc;
        if (old + 1u == (gen + 1u) * nloc) {
            __builtin_amdgcn_fence(__ATOMIC_RELEASE, "agent");
            asm volatile("s_waitcnt vmcnt(0)" ::: "memory");
            const unsigned og = xb_add(&bar[XB_TOP], 1u);
            const unsigned tg = og / nx;
            if (og + 1u == (tg + 1u) * nx) xb_add(&bar[XB_TOPGEN], 1u);
            else XB_SPIN(xb_ld(&bar[XB_TOPGEN]) == tg, bar);
            __builtin_amdgcn_fence(__ATOMIC_ACQUIRE, "agent");
            xb_add(&bar[XB_XGEN(b.x)], 1u);
            asm volatile("s_waitcnt vmcnt(0)" ::: "memory");
        } else {
            XB_SPIN(xb_ld(&bar[XB_XGEN(b.x)]) == gen, bar);
            __builtin_amdgcn_fence(__ATOMIC_ACQUIRE, "agent");
            asm volatile("s_waitcnt vmcnt(0)" ::: "memory");
        }
    }
    __syncthreads();
}
struct Frame {
    LAS unsigned char* lds;
    volatile LAS unsigned* MISC;
    gu32* ctl;
    int tid, lane, wave;
    int vcu, G;
};
__device__ __forceinline__ float wave_sum(float v) {
#pragma unroll
    for (int o = 1; o < 64; o <<= 1) v += __shfl_xor(v, o);
    return v;
}
__device__ __forceinline__ void p0_transpose_item(const float* W, int K, int N, bf16* WT, int ldk, LAS float* scr, int item, int lane) {
    const int nblk = N / 32, kb = item / nblk, nb = item % nblk, k0 = 64 * kb, n0 = 32 * nb;
#pragma unroll 8
    for (int i = 0; i < 32; ++i) { const int kk = 2 * i + (lane >> 5); scr[kk * 33 + (lane & 31)] = W[(size_t)(k0 + kk) * N + n0 + (lane & 31)]; }
    LDS_WAIT(); asm volatile("" ::: "memory");
    const int c = lane & 7;
#pragma unroll
    for (int j = 0; j < 4; ++j) { const int n = (lane >> 3) + 8 * j; const LAS float* s = scr + (8 * c) * 33 + n;
        v4u o; o.x = pk2(s[0 * 33], s[1 * 33]); o.y = pk2(s[2 * 33], s[3 * 33]); o.z = pk2(s[4 * 33], s[5 * 33]); o.w = pk2(s[6 * 33], s[7 * 33]);
        *(GAS v4u*)(WT + (size_t)(n0 + n) * ldk + k0 + 8 * c) = o; }
    LDS_WAIT(); asm volatile("" ::: "memory");
}
struct WDesc { const float* W; int K, N; bf16* WT; int ldk; };
typedef float f32x2g __attribute__((ext_vector_type(2)));
__device__ __forceinline__ void p0_prologue(Frame& F, const float* x, const float* g0, const float* wqkv, const float* wo, const float* wu0, const float* wd0, const float* win, const float* wout, const float* wu1, const float* wd1, unsigned char* ws) {
    LAS float* scr = (LAS float*)(F.lds + RING_OFF + F.wave * 16384);
    const int gw = F.vcu * NWAVES + F.wave, NGW = F.G * NWAVES;
    int it = gw;
#define P0_MAT(Wp, K_, N_, off, ldk_) { constexpr int NI = ((K_) / 64) * ((N_) / 32); for (; it < NI; it += NGW) p0_transpose_item((Wp), (K_), (N_), (bf16*)(ws + (off)), (ldk_), scr, it, F.lane); it -= NI; }
    P0_MAT(wqkv, D, 2880, WS_WQKV, D)
    P0_MAT(wo, AW, D, WS_WO, D)
    P0_MAT(wu0, D, FF, WS_WU0, D)
    P0_MAT(wd0, FF, D, WS_WD0, FF)
    P0_MAT(win, D, 3 * D, WS_WIN, D)
    P0_MAT(wout, D, D, WS_WOUT, D)
    P0_MAT(wu1, D, FF, WS_WU1, D)
    P0_MAT(wd1, FF, D, WS_WD1, FF)
#undef P0_MAT
    const int gt = F.vcu * (NWAVES * 64) + F.tid, NGT = F.G * NWAVES * 64;
    { GAS v4u* z = (GAS v4u*)(ws + WS_WQKV + (size_t)2880 * D * 2); for (int i = gt; i < 24576; i += NGT) z[i] = (v4u){0u, 0u, 0u, 0u}; }
    for (int i = gt; i < 8192; i += NGT) { const int r = i >> 3, c = i & 7; *(GAS v4u*)(ws + WS_WO + (size_t)r * D * 2 + 1920 + 16 * c) = (v4u){0u, 0u, 0u, 0u}; }
    for (int i = gt; i < SEQ * 32; i += NGT) { const int pos = i >> 5, fi = i & 31;
        const float inv = exp2f(-(float)fi * (13.287712379549449f / 32.0f));
        double rev = (double)pos * (double)inv * 0.15915494309189535; rev -= floor(rev); const float rf = (float)rev;
        f32x2g o; o.x = __builtin_amdgcn_cosf(rf); o.y = __builtin_amdgcn_sinf(rf); ((GAS f32x2g*)(ws + WS_CS))[i] = o; }
    { const float* g = g0; bf16* XN = (bf16*)(ws + WS_XN);
      f32x4 gv[4];
#pragma unroll
      for (int j = 0; j < 4; ++j) gv[j] = ((const GAS f32x4*)g)[F.lane + 64 * j];
      for (int m = gw; m < M; m += NGW) { const GAS f32x4* xr = (const GAS f32x4*)(x + (size_t)m * D) + F.lane; f32x4 v[4]; float s = 0.f;
#pragma unroll
          for (int j = 0; j < 4; ++j) { v[j] = xr[64 * j]; s += (v[j].x * v[j].x + v[j].y * v[j].y) + (v[j].z * v[j].z + v[j].w * v[j].w); }
          const float rstd = __builtin_amdgcn_rsqf(wave_sum(s) * (1.f / D) + 1e-6f);
          GAS unsigned long long* o8 = (GAS unsigned long long*)(XN + (size_t)m * D) + F.lane;
#pragma unroll
          for (int j = 0; j < 4; ++j) { const f32x4 t = v[j] * gv[j] * rstd; o8[64 * j] = (unsigned long long)pk2(t.x, t.y) | ((unsigned long long)pk2(t.z, t.w) << 32); } } }
}
namespace att {
typedef short bf16x8 __attribute__((ext_vector_type(8)));
typedef float f32x16 __attribute__((ext_vector_type(16)));
typedef float f32x4 __attribute__((ext_vector_type(4)));
typedef unsigned u32x4 __attribute__((ext_vector_type(4)));
typedef unsigned u32x2 __attribute__((ext_vector_type(2)));
typedef short v4i16_t __attribute__((ext_vector_type(4)));
#define ALAS __attribute__((address_space(3)))
constexpr int VPITCH = 192, VBLK = 32 * VPITCH;
constexpr int QKVP = 3072;
constexpr float C2 = 0.125f * 1.4426950408889634f;
__device__ __forceinline__ unsigned cvtpk(float lo, float hi) { unsigned r; asm volatile("v_cvt_pk_bf16_f32 %0, %1, %2" : "=v"(r) : "v"(lo), "v"(hi)); return r; }
__device__ __forceinline__ float bflo(unsigned w) { return __uint_as_float(w << 16); }
__device__ __forceinline__ float bfhi(unsigned w) { return __uint_as_float(w & 0xffff0000u); }
__device__ __forceinline__ int crow(int r, int hi) { return (r & 3) + 8 * (r >> 2) + 4 * hi; }
__device__ __forceinline__ void load_norm_rope(const unsigned short* p, const float* gain, const float* cs_row, int hi, float scale, bf16x8 (&frag)[4]) {
    u32x4 raw[4];
#pragma unroll
    for (int ks = 0; ks < 4; ++ks) raw[ks] = *(const u32x4*)(p + 16 * ks + 8 * hi);
    float ssq = 0.f;
#pragma unroll
    for (int ks = 0; ks < 4; ++ks)
#pragma unroll
        for (int e = 0; e < 4; ++e) { const float a = bflo(raw[ks][e]), b = bfhi(raw[ks][e]); ssq += a * a + b * b; }
    ssq += __shfl_xor(ssq, 32);
    const float rs = __builtin_amdgcn_rsqf(ssq * (1.0f / 64.0f) + 1e-6f) * scale;
#pragma unroll
    for (int p2 = 0; p2 < 2; ++p2) {
        const int d1 = 16 * p2 + 8 * hi;
        const f32x4 g1a = *(const f32x4*)(gain + d1), g1b = *(const f32x4*)(gain + d1 + 4), g2a = *(const f32x4*)(gain + 32 + d1), g2b = *(const f32x4*)(gain + 32 + d1 + 4);
        const float g1[8] = {g1a[0], g1a[1], g1a[2], g1a[3], g1b[0], g1b[1], g1b[2], g1b[3]};
        const float g2[8] = {g2a[0], g2a[1], g2a[2], g2a[3], g2b[0], g2b[1], g2b[2], g2b[3]};
        u32x4 o1, o2;
#pragma unroll
        for (int e = 0; e < 4; ++e) { const f32x4 t = *(const f32x4*)(cs_row + 2 * d1 + 4 * e);
            const float x1l = bflo(raw[p2][e]) * (g1[2 * e] * rs), x1h = bfhi(raw[p2][e]) * (g1[2 * e + 1] * rs);
            const float x2l = bflo(raw[p2 + 2][e]) * (g2[2 * e] * rs), x2h = bfhi(raw[p2 + 2][e]) * (g2[2 * e + 1] * rs);
            o1[e] = cvtpk(x1l * t[0] - x2l * t[1], x1h * t[2] - x2h * t[3]);
            o2[e] = cvtpk(x2l * t[0] + x1l * t[1], x2h * t[2] + x1h * t[3]); }
        frag[p2] = __builtin_bit_cast(bf16x8, o1); frag[p2 + 2] = __builtin_bit_cast(bf16x8, o2);
    }
}
__device__ __forceinline__ void attn_job(const unsigned short* QKV, unsigned short* O, float* LSE, const float* qg, const float* kg, const float* CS, ALAS unsigned char* vlds, int b, int h, int t, int lane) {
    const int r32 = lane & 31, hi = lane >> 5;
    const int sh = 2 * (h / 5);
    const int nlog = 6 - sh, res = t >> nlog, j0 = (t & ((1 << nlog) - 1)) * 32, L = SEQ >> sh;
    const size_t rowb = (size_t)b * SEQ;
    const int posq = ((j0 + r32) << sh) + res;
    bf16x8 qf[4];
    load_norm_rope(QKV + (rowb + posq) * QKVP + h * 64, qg, CS + posq * 64, hi, C2, qf);
    f32x16 S[5];
    const float NEG = -INFINITY;
#pragma unroll
    for (int kb = 0; kb < 5; ++kb) {
        const int jb = j0 + 32 * (kb - 2);
        if (jb >= 0 && jb < L) {
            const int posk = ((jb + r32) << sh) + res;
            bf16x8 kf[4];
            load_norm_rope(QKV + (rowb + posk) * QKVP + AW + h * 64, kg, CS + posk * 64, hi, 1.0f, kf);
            f32x16 a = {};
#pragma unroll
            for (int ks = 0; ks < 4; ++ks) a = __builtin_amdgcn_mfma_f32_32x32x16_bf16(kf[ks], qf[ks], a, 0, 0, 0);
            if (kb == 0) {
#pragma unroll
                for (int r = 0; r < 16; ++r) if (crow(r, hi) < r32) a[r] = NEG; }
            if (kb == 4) {
#pragma unroll
                for (int r = 0; r < 16; ++r) if (crow(r, hi) > r32) a[r] = NEG; }
            S[kb] = a;
        } else {
#pragma unroll
            for (int r = 0; r < 16; ++r) S[kb][r] = NEG;
        }
    }
    float mx = NEG;
#pragma unroll
    for (int kb = 0; kb < 5; ++kb)
#pragma unroll
        for (int r = 0; r < 16; ++r) mx = fmaxf(mx, S[kb][r]);
    mx = fmaxf(mx, __shfl_xor(mx, 32));
    float sum = 0.f;
#pragma unroll
    for (int kb = 0; kb < 5; ++kb)
#pragma unroll
        for (int r = 0; r < 16; ++r) { const float p = __builtin_amdgcn_exp2f(S[kb][r] - mx); S[kb][r] = p; sum += p; }
    sum += __shfl_xor(sum, 32);
    f32x16 o0 = {}, o1 = {};
    const int g4 = lane >> 4, i16 = lane & 15;
    const int troff = (4 * hi + (i16 >> 2)) * VPITCH + (16 * (g4 & 1) + 4 * (i16 & 3)) * 2;
    const int rr = lane >> 1, half = lane & 1;
#pragma unroll
    for (int kb = 0; kb < 5; ++kb) {
        const int jb = j0 + 32 * (kb - 2);
        if (jb >= 0 && jb < L) {
            const int posv = ((jb + rr) << sh) + res;
            const u32x4* src = (const u32x4*)(QKV + (rowb + posv) * QKVP + 2 * AW + h * 64 + half * 32);
            const u32x4 v0 = src[0], v1 = src[1], v2 = src[2], v3 = src[3];
            asm volatile("" ::: "memory");
            ALAS u32x4* dst = (ALAS u32x4*)(vlds + rr * VPITCH + half * 64);
            dst[0] = v0; dst[1] = v1; dst[2] = v2; dst[3] = v3;
            asm volatile("s_waitcnt lgkmcnt(0)" ::: "memory");
#pragma unroll
            for (int s = 0; s < 2; ++s) {
                u32x4 pw; pw[0] = cvtpk(S[kb][8 * s + 0], S[kb][8 * s + 1]); pw[1] = cvtpk(S[kb][8 * s + 2], S[kb][8 * s + 3]); pw[2] = cvtpk(S[kb][8 * s + 4], S[kb][8 * s + 5]); pw[3] = cvtpk(S[kb][8 * s + 6], S[kb][8 * s + 7]);
                const bf16x8 pf = __builtin_bit_cast(bf16x8, pw);
#pragma unroll
                for (int db = 0; db < 2; ++db) {
                    ALAS unsigned char* tp = vlds + troff + 16 * s * VPITCH + db * 64;
                    const v4i16_t lo = __builtin_amdgcn_ds_read_tr16_b64_v4i16((ALAS v4i16_t*)tp);
                    const v4i16_t hh = __builtin_amdgcn_ds_read_tr16_b64_v4i16((ALAS v4i16_t*)(tp + 8 * VPITCH));
                    const bf16x8 vf = (bf16x8){lo[0], lo[1], lo[2], lo[3], hh[0], hh[1], hh[2], hh[3]};
                    if (db == 0) o0 = __builtin_amdgcn_mfma_f32_32x32x16_bf16(vf, pf, o0, 0, 0, 0); else o1 = __builtin_amdgcn_mfma_f32_32x32x16_bf16(vf, pf, o1, 0, 0, 0);
                }
            }
            asm volatile("s_waitcnt lgkmcnt(0)" ::: "memory");
        }
    }
    const float inv = 1.0f / sum;
    unsigned short* orow = O + (rowb + posq) * D + h * 64 + 4 * hi;
#pragma unroll
    for (int t4 = 0; t4 < 4; ++t4) {
        u32x2 w0, w1; w0.x = cvtpk(o0[4 * t4] * inv, o0[4 * t4 + 1] * inv); w0.y = cvtpk(o0[4 * t4 + 2] * inv, o0[4 * t4 + 3] * inv);
        w1.x = cvtpk(o1[4 * t4] * inv, o1[4 * t4 + 1] * inv); w1.y = cvtpk(o1[4 * t4 + 2] * inv, o1[4 * t4 + 3] * inv);
        *(u32x2*)(orow + 8 * t4) = w0; *(u32x2*)(orow + 32 + 8 * t4) = w1; }
    if (hi == 0) LSE[(rowb + posq) * 16 + h] = (mx + __builtin_amdgcn_logf(sum)) * 0.6931471805599453f;
}
__device__ __forceinline__ void attn_phase(Frame& F, unsigned char* ws, const float* qg, const float* kg) {
    ALAS unsigned char* vlds = (ALAS unsigned char*)(F.lds + RING_OFF + F.wave * VBLK);
    const unsigned short* QKV = (const unsigned short*)(ws + WS_BIG); unsigned short* O = (unsigned short*)(ws + WS_O); float* LSE = (float*)(ws + WS_LSE); const float* CS = (const float*)(ws + WS_CS);
    for (int u = F.vcu; u < BATCH * NH * 8; u += F.G) { const int bh = u >> 3, sub = u & 7; attn_job(QKV, O, LSE, qg, kg, CS, vlds, bh / NH, bh % NH, sub * 8 + F.wave, F.lane); }
}
}
__device__ __forceinline__ void weight_pass(Frame& F, unsigned char* ws) {
    const int gw = F.vcu * NWAVES + F.wave, NGW = F.G * NWAVES; const float* LSE = (const float*)(ws + WS_LSE);
    const int hh = F.lane >> 2, g = hh / 5, j = hh - 5 * g;
    for (int m = gw; m < M; m += NGW) { GAS v4u* p = (GAS v4u*)(ws + WS_O + (size_t)m * D * 2) + 2 * F.lane;
        if (hh < NH) { const float l0 = LSE[m * 16 + j], l1 = LSE[m * 16 + 5 + j], l2 = LSE[m * 16 + 10 + j]; const float mx = fmaxf(l0, fmaxf(l1, l2));
            const float e0 = __expf(l0 - mx), e1 = __expf(l1 - mx), e2 = __expf(l2 - mx); const float w = (g == 0 ? e0 : (g == 1 ? e1 : e2)) / (e0 + e1 + e2);
#pragma unroll
            for (int k = 0; k < 2; ++k) { v4u v = p[k];
#pragma unroll
                for (int e = 0; e < 4; ++e) v[e] = att::cvtpk(att::bflo(v[e]) * w, att::bfhi(v[e]) * w);
                p[k] = v; }
        } else { p[0] = (v4u){0u, 0u, 0u, 0u}; p[1] = (v4u){0u, 0u, 0u, 0u}; } }
}
__device__ __forceinline__ void conv_pass(Frame& F, unsigned char* ws, const float* cw) {
    const int gw = F.vcu * NWAVES + F.wave, NGW = F.G * NWAVES; const int c0 = 16 * F.lane;
    float w0[16], w1[16], w2[16];
#pragma unroll
    for (int k = 0; k < 4; ++k) { const f32x4 a = *(const GAS f32x4*)(cw + c0 + 4 * k), b = *(const GAS f32x4*)(cw + D + c0 + 4 * k), c = *(const GAS f32x4*)(cw + 2 * D + c0 + 4 * k);
#pragma unroll
        for (int e = 0; e < 4; ++e) { w0[4 * k + e] = a[e]; w1[4 * k + e] = b[e]; w2[4 * k + e] = c[e]; } }
    const bf16* BCU = (const bf16*)(ws + WS_BIG); bf16* Z = (bf16*)(ws + WS_O);
    for (int m = gw; m < M; m += NGW) { const int s = m & (SEQ - 1);
        float y[16];
#pragma unroll
        for (int e = 0; e < 16; ++e) y[e] = 0.f;
#pragma unroll
        for (int dr = -1; dr <= 1; ++dr) { if (s + dr < 0 || s + dr >= SEQ) continue; const bf16* row = BCU + (size_t)(m + dr) * 3072 + c0;
#pragma unroll
            for (int k = 0; k < 2; ++k) { const v4u cv = *(const GAS v4u*)(row + D + 8 * k), uv = *(const GAS v4u*)(row + 2 * D + 8 * k);
#pragma unroll
                for (int e = 0; e < 4; ++e) { const float culo = att::bflo(cv[e]) * att::bflo(uv[e]), cuhi = att::bfhi(cv[e]) * att::bfhi(uv[e]); const int i = 8 * k + 2 * e;
                    y[i] += (dr < 0 ? w0[i] : (dr == 0 ? w1[i] : w2[i])) * culo; y[i + 1] += (dr < 0 ? w0[i + 1] : (dr == 0 ? w1[i + 1] : w2[i + 1])) * cuhi; } } }
        const bf16* brow = BCU + (size_t)m * 3072 + c0;
#pragma unroll
        for (int k = 0; k < 2; ++k) { const v4u bv = *(const GAS v4u*)(brow + 8 * k); v4u o;
#pragma unroll
            for (int e = 0; e < 4; ++e) o[e] = att::cvtpk(att::bflo(bv[e]) * y[8 * k + 2 * e], att::bfhi(bv[e]) * y[8 * k + 2 * e + 1]);
            *(GAS v4u*)(Z + (size_t)m * D + c0 + 8 * k) = o; } }
}
__device__ __forceinline__ void final_pass(Frame& F, float* out, const float* ss, const float* g) {
    const int gw = F.vcu * NWAVES + F.wave, NGW = F.G * NWAVES;
    f32x4 gv[4];
#pragma unroll
    for (int j = 0; j < 4; ++j) gv[j] = ((const GAS f32x4*)g)[F.lane + 64 * j];
    for (int m = gw; m < M; m += NGW) { GAS f32x4* xr = (GAS f32x4*)(out + (size_t)m * D) + F.lane; const float rstd = __builtin_amdgcn_rsqf(ss[m] * (1.f / D) + 1e-6f);
#pragma unroll
        for (int j = 0; j < 4; ++j) xr[64 * j] = xr[64 * j] * gv[j] * rstd; }
}
struct Args { const float* in[N_IN]; float* out; unsigned char* ws; int ph_lo, ph_hi; };
__global__ void __launch_bounds__(NWAVES * 64, 2) fwd_megakernel(Args args) {
    extern __shared__ __attribute__((aligned(16))) unsigned char lds[];
    Frame F;
    F.lds = (LAS unsigned char*)lds;
    F.MISC = (volatile LAS unsigned*)(F.lds + MISC_OFF);
    F.tid = threadIdx.x; F.lane = F.tid & 63; F.wave = __builtin_amdgcn_readfirstlane(F.tid >> 6);
    F.G = gridDim.x; { const int bx = blockIdx.x; F.vcu = (F.G % 8 == 0) ? (bx % 8) * (F.G / 8) + bx / 8 : bx; }
    unsigned char* ws = args.ws;
    F.ctl = (gu32*)(ws + WS_CTL);
    for (int u = F.tid; u < (LDS_BYTES - LDSCTL_OFF) / 4; u += NWAVES * 64) ((LAS unsigned*)(F.lds + LDSCTL_OFF))[u] = 0u;
    __syncthreads();
    XcdBarrier bar; bar.bar = (unsigned*)(F.ctl + CW_BAR); bar.x = 0; bar.st = nullptr;
#if !MK_PER_PHASE && !MK_CG_SYNC
    bar = xcd_barrier_post((unsigned*)(F.ctl + CW_BAR), F.MISC + 8);
#endif
    const int lo = args.ph_lo, hi = args.ph_hi;
#define IN(k) (lo <= (k) && (k) < hi)
#if MK_PER_PHASE
#define SEAM(k) do { } while (0)
#define SEAM_CG(k) do { } while (0)
#elif MK_CG_SYNC
#define SEAM(k) do { cg::this_grid().sync(); } while (0)
#define SEAM_CG(k) SEAM(k)
#else
#define SEAM(k) do { xcd_barrier(bar); } while (0)
#define SEAM_CG(k) do { cg::this_grid().sync(); } while (0)
#endif
    float* X = args.out;
    float* SS = (float*)(ws + WS_SS);
    bf16* XN = (bf16*)(ws + WS_XN); bf16* BIG = (bf16*)(ws + WS_BIG); bf16* OB = (bf16*)(ws + WS_O);
    if (IN(0)) { p0_prologue(F, args.in[0], args.in[1], args.in[2], args.in[5], args.in[7], args.in[8], args.in[10], args.in[12], args.in[14], args.in[15], ws); SEAM_CG(0); }
    if (IN(1)) { pg8::Gemm g{XN, (const bf16*)(ws + WS_WQKV), M, NQKV, D}; pg8::StaticOrder S; S.init(M, NQKV, F.G, (int)blockIdx.x);
        pg8::EpiBf16S<0> E{BIG, NQKV, nullptr};
        pg8::gemm_phase<pg8::EpiBf16S<0>, pg8::StaticOrder, true, true>(F.lds + RING_OFF, g, S, E); SEAM(1); }
    if (IN(2)) { att::attn_phase(F, ws, args.in[3], args.in[4]); SEAM(2); }
    if (IN(3)) { weight_pass(F, ws); SEAM(3); }
    if (IN(4)) { pg8::Gemm g{OB, (const bf16*)(ws + WS_WO), M, D, D}; pg8::StaticOrder S; S.init(M, D, F.G, (int)blockIdx.x);
        pg8::EpiRes E{args.in[0], X, XN, args.in[6], SS, D};
        pg8::gemm_phase<pg8::EpiRes, pg8::StaticOrder, true, true>(F.lds + RING_OFF, g, S, E); SEAM(4); }
    if (IN(5)) { pg8::Gemm g{XN, (const bf16*)(ws + WS_WU0), M, FF, D}; pg8::StaticOrder S; S.init(M, FF, F.G, (int)blockIdx.x);
        pg8::EpiBf16S<1> E{BIG, FF, SS};
        pg8::gemm_phase<pg8::EpiBf16S<1>, pg8::StaticOrder, true, true>(F.lds + RING_OFF, g, S, E); SEAM(5); }
    if (IN(6)) { pg8::Gemm g{BIG, (const bf16*)(ws + WS_WD0), M, D, FF}; pg8::StaticOrder S; S.init(M, D, F.G, (int)blockIdx.x);
        pg8::EpiRes E{X, X, XN, args.in[9], SS + M, D};
        pg8::gemm_phase<pg8::EpiRes, pg8::StaticOrder, true, true>(F.lds + RING_OFF, g, S, E); SEAM(6); }
    if (IN(7)) { pg8::Gemm g{XN, (const bf16*)(ws + WS_WIN), M, 3 * D, D}; pg8::StaticOrder S; S.init(M, 3 * D, F.G, (int)blockIdx.x);
        pg8::EpiBf16S<0> E{BIG, 3 * D, SS + M};
        pg8::gemm_phase<pg8::EpiBf16S<0>, pg8::StaticOrder, true, true>(F.lds + RING_OFF, g, S, E); SEAM(7); }
    if (IN(8)) { conv_pass(F, ws, args.in[11]); SEAM(8); }
    if (IN(9)) { pg8::Gemm g{OB, (const bf16*)(ws + WS_WOUT), M, D, D}; pg8::StaticOrder S; S.init(M, D, F.G, (int)blockIdx.x);
        pg8::EpiRes E{X, X, XN, args.in[13], SS + 2 * M, D};
        pg8::gemm_phase<pg8::EpiRes, pg8::StaticOrder, true, true>(F.lds + RING_OFF, g, S, E); SEAM(9); }
    if (IN(10)) { pg8::Gemm g{XN, (const bf16*)(ws + WS_WU1), M, FF, D}; pg8::StaticOrder S; S.init(M, FF, F.G, (int)blockIdx.x);
        pg8::EpiBf16S<1> E{BIG, FF, SS + 2 * M};
        pg8::gemm_phase<pg8::EpiBf16S<1>, pg8::StaticOrder, true, true>(F.lds + RING_OFF, g, S, E); SEAM(10); }
    if (IN(11)) { pg8::Gemm g{BIG, (const bf16*)(ws + WS_WD1), M, D, FF}; pg8::StaticOrder S; S.init(M, D, F.G, (int)blockIdx.x);
        pg8::EpiRes E{X, X, nullptr, nullptr, SS + 3 * M, D};
        pg8::gemm_phase<pg8::EpiRes, pg8::StaticOrder, true, true>(F.lds + RING_OFF, g, S, E); SEAM(11); }
    if (IN(12)) { final_pass(F, X, SS + 3 * M, args.in[16]); }
#undef IN
}

extern "C" void kernel_launch(void* const* d_in, const int* in_sizes, int n_in, void* d_out, int out_size, void* d_ws, size_t ws_size, hipStream_t stream) {
    static int grid = 0;
    if (grid == 0) {
        if (n_in != N_IN || in_sizes[0] != M * D || out_size != M * D || ws_size < WS_END) { fprintf(stderr, "kernel_launch: unexpected shapes (n_in %d, in0 %d, out %d, ws %zu)\n", n_in, n_in > 0 ? in_sizes[0] : -1, out_size, ws_size); grid = -1; return; }
        int dev = 0, cus = 0, per_cu = 0;
        if (hipGetDevice(&dev) != hipSuccess || hipDeviceGetAttribute(&cus, hipDeviceAttributeMultiprocessorCount, dev) != hipSuccess) { grid = -1; return; }
        if (hipFuncSetAttribute((const void*)fwd_megakernel, hipFuncAttributeMaxDynamicSharedMemorySize, LDS_BYTES) != hipSuccess) { fprintf(stderr, "kernel_launch: hipFuncSetAttribute failed\n"); grid = -1; return; }
        if (hipOccupancyMaxActiveBlocksPerMultiprocessor(&per_cu, (const void*)fwd_megakernel, NWAVES * 64, LDS_BYTES) != hipSuccess || per_cu < 1) { fprintf(stderr, "kernel_launch: occupancy query says %d\n", per_cu); per_cu = 1; }
        (void)hipGetLastError();
        grid = cus;
    }
    if (grid < 0) return;
    (void)hipMemsetAsync((char*)d_ws + WS_CTL, 0, CTL_ZERO_BYTES, stream);
    Args a{};
    for (int i = 0; i < N_IN; ++i) a.in[i] = (const float*)d_in[i];
    a.out = (float*)d_out; a.ws = (unsigned char*)d_ws;
#if MK_PER_PHASE
    for (int p = 0; p < N_PHASES; ++p) { a.ph_lo = p; a.ph_hi = p + 1; hipLaunchKernelGGL(fwd_megakernel, dim3(grid), dim3(NWAVES * 64), LDS_BYTES, stream, a); }
#else
    a.ph_lo = 0; a.ph_hi = N_PHASES;
    void* kargs[] = {&a};
    const hipError_t le = hipLaunchCooperativeKernel((const void*)fwd_megakernel, dim3(grid), dim3(NWAVES * 64), kargs, LDS_BYTES, stream);
    if (le != hipSuccess) fprintf(stderr, "kernel_launch: cooperative launch failed: %s (grid %d)\n", hipGetErrorString(le), grid);
#endif
}
```
